# Optimizing an MI355X kernel written in HIP

```python
import jax, jax.numpy as jnp
from jax import lax
import numpy as np

D_MODEL = 1024
BATCH = 8
SEQ = 2048
DEPTH = 1

MIX_WIDTH = D_MODEL
HEAD_DIM = 64
ATTN_WIDTH = MIX_WIDTH // 2
ATTN_HEADS = ATTN_WIDTH // HEAD_DIM
SGU_WIDTH = MIX_WIDTH - ATTN_WIDTH
SGU_GROUP_DIM = 64
SGU_GROUPS = SGU_WIDTH // SGU_GROUP_DIM
SGU_CHUNK = 128
DILATED_PATTERNS = ((128, 1), (512, 4), (2048, 16))
BLOCK_Q = 128
ROPE_THETA = 500000.0
ROT_DIM = HEAD_DIM // 4
ROT_HALF = ROT_DIM // 2
D_FF = ((8 * D_MODEL // 3 + 255) // 256) * 256
IN_PROJ_WIDTH = 3 * ATTN_WIDTH + 2 * SGU_WIDTH
RMS_EPS = 1e-6
LN_EPS = 1e-5

kernel_name = "hymba_dilated_attn_gmlp_sandwich_block"


def rms_norm(x, gain):
    xf = x.astype(jnp.float32)
    y = xf * lax.rsqrt(jnp.mean(xf * xf, axis=-1, keepdims=True) + RMS_EPS)
    return (y * gain.astype(jnp.float32)).astype(x.dtype)


def layer_norm(x, gain, bias):
    xf = x.astype(jnp.float32)
    mu = jnp.mean(xf, axis=-1, keepdims=True)
    xc = xf - mu
    y = xc * lax.rsqrt(jnp.mean(xc * xc, axis=-1, keepdims=True) + LN_EPS)
    return (y * gain.astype(jnp.float32) + bias.astype(jnp.float32)).astype(x.dtype)


def partial_rotary(x, positions):
    inv_freq = ROPE_THETA ** (-jnp.arange(0, ROT_DIM, 2, dtype=jnp.float32) / ROT_DIM)
    ang = positions.astype(jnp.float32)[:, :, None, None] * inv_freq
    cos, sin = jnp.cos(ang), jnp.sin(ang)
    xf = x.astype(jnp.float32)
    x1 = xf[..., :ROT_HALF]
    x2 = xf[..., ROT_HALF:ROT_DIM]
    out = jnp.concatenate([x1 * cos - x2 * sin, x2 * cos + x1 * sin, xf[..., ROT_DIM:]], axis=-1)
    return out.astype(x.dtype)


def dilated_window_attention(q, k, v, window, dilation):
    B, H, S, Dh = q.shape
    L = S // dilation
    W = window // dilation
    nblk = -(-L // BLOCK_Q)
    Lp = nblk * BLOCK_Q

    def strided(t):
        return t.reshape(B, H, L, dilation, Dh).transpose(0, 1, 3, 2, 4)

    qs, ks, vs = strided(q), strided(k), strided(v)
    qs = jnp.pad(qs, ((0, 0), (0, 0), (0, 0), (0, Lp - L), (0, 0)))
    kv_pad = ((0, 0), (0, 0), (0, 0), (W, Lp - L), (0, 0))
    kp = jnp.pad(ks, kv_pad)
    vp = jnp.pad(vs, kv_pad)
    blk = jnp.arange(nblk)[:, None]
    col = jnp.arange(BLOCK_Q + W)[None, :]
    idx = blk * BLOCK_Q + col
    kb = kp[:, :, :, idx]
    vb = vp[:, :, :, idx]
    qb = qs.reshape(B, H, dilation, nblk, BLOCK_Q, Dh)

    scale = 1.0 / np.sqrt(HEAD_DIM)
    s = jnp.einsum('bhrnqd,bhrnkd->bhrnqk', qb, kb,
                   preferred_element_type=jnp.float32) * scale
    row = jnp.arange(BLOCK_Q)[:, None]
    dist = row + W - jnp.arange(BLOCK_Q + W)[None, :]
    key_pos = jnp.arange(nblk)[:, None, None] * BLOCK_Q + jnp.arange(BLOCK_Q + W)[None, None, :] - W
    mask = (dist >= 0)[None] & (dist <= W)[None] & (key_pos >= 0)
    s = jnp.where(mask, s, jnp.finfo(jnp.float32).min)
    m = jnp.max(s, axis=-1, keepdims=True)
    p = jnp.exp(s - m)
    denom = jnp.sum(p, axis=-1, keepdims=True)
    o = jnp.einsum('bhrnqk,bhrnkd->bhrnqd', p, vb.astype(jnp.float32)) / denom
    lse = (m + jnp.log(denom))[..., 0]
    o = o.reshape(B, H, dilation, Lp, Dh)[:, :, :, :L]
    lse = lse.reshape(B, H, dilation, Lp)[:, :, :, :L]
    o = o.transpose(0, 1, 3, 2, 4).reshape(B, H, S, Dh)
    lse = lse.transpose(0, 1, 3, 2).reshape(B, H, S)
    return o, lse


def dilated_mixture_attention(q, k, v):
    outs, lses = [], []
    for window, dilation in DILATED_PATTERNS:
        o, lse = dilated_window_attention(q, k, v, window, dilation)
        outs.append(o)
        lses.append(lse)
    wts = jax.nn.softmax(jnp.stack(lses, axis=0), axis=0)
    o = jnp.sum(wts[..., None] * jnp.stack(outs, axis=0), axis=0)
    return o.astype(q.dtype)


def spatial_gating(u, v, ln_gain, ln_bias, w_spatial, b_spatial):
    B, S, _ = u.shape
    u = jax.nn.gelu(u, approximate=False)
    v = layer_norm(jax.nn.gelu(v, approximate=False), ln_gain, ln_bias)
    vc = v.reshape(B, S // SGU_CHUNK, SGU_CHUNK, SGU_GROUPS, SGU_GROUP_DIM)
    causal = jnp.tril(jnp.ones((SGU_CHUNK, SGU_CHUNK), dtype=bool))
    w = jnp.where(causal[None], w_spatial, 0.0).astype(v.dtype)
    mixed = jnp.einsum('gij,bnjgc->bnigc', w, vc) + b_spatial.T[:, :, None].astype(v.dtype)
    return u * mixed.reshape(B, S, SGU_WIDTH)


def setup_inputs(seed: int = 0) -> dict:
    key = jax.random.key(seed)
    ks = jax.random.split(key, 20)
    f32 = jnp.float32

    def nrm(k, shape, scale):
        return jax.random.normal(k, shape, f32) * scale

    def gain(k, width):
        return 1.0 + 0.05 * jax.random.normal(k, (DEPTH, width), f32)

    x = jax.random.normal(ks[0], (BATCH, SEQ, D_MODEL), f32)
    offsets = jax.random.randint(ks[1], (BATCH, 1), 0, 4096, dtype=jnp.int32)
    positions = (jnp.arange(SEQ, dtype=jnp.int32)[None, :] + offsets).astype(jnp.int32)
    return {
        "x": x,
        "positions": positions,
        "pre_mix_norm": gain(ks[2], D_MODEL),
        "w_in": nrm(ks[3], (DEPTH, D_MODEL, IN_PROJ_WIDTH), D_MODEL ** -0.5),
        "sgu_ln_gain": gain(ks[4], SGU_WIDTH),
        "sgu_ln_bias": nrm(ks[5], (DEPTH, SGU_WIDTH), 0.02),
        "sgu_w_spatial": nrm(ks[6], (DEPTH, SGU_GROUPS, SGU_CHUNK, SGU_CHUNK), 0.5 * SGU_CHUNK ** -0.5),
        "sgu_b_spatial": 1.0 + nrm(ks[7], (DEPTH, SGU_GROUPS, SGU_CHUNK), 0.1),
        "attn_out_norm": gain(ks[8], ATTN_WIDTH),
        "sgu_out_norm": gain(ks[9], SGU_WIDTH),
        "w_out": nrm(ks[10], (DEPTH, MIX_WIDTH, D_MODEL), MIX_WIDTH ** -0.5),
        "post_mix_norm": gain(ks[11], D_MODEL),
        "pre_ffn_norm": gain(ks[12], D_MODEL),
        "w_gate": nrm(ks[13], (DEPTH, D_MODEL, D_FF), D_MODEL ** -0.5),
        "w_up": nrm(ks[14], (DEPTH, D_MODEL, D_FF), D_MODEL ** -0.5),
        "w_down": nrm(ks[15], (DEPTH, D_FF, D_MODEL), D_FF ** -0.5),
        "post_ffn_norm": gain(ks[16], D_MODEL),
    }


def reference(x, positions, pre_mix_norm, w_in, sgu_ln_gain, sgu_ln_bias, sgu_w_spatial,
              sgu_b_spatial, attn_out_norm, sgu_out_norm, w_out, post_mix_norm,
              pre_ffn_norm, w_gate, w_up, w_down, post_ffn_norm):
    B, S, _ = x.shape
    for l in range(DEPTH):
        h = rms_norm(x, pre_mix_norm[l])
        proj = h @ w_in[l]
        q, k, v_a, u, v_s = jnp.split(
            proj, [ATTN_WIDTH, 2 * ATTN_WIDTH, 3 * ATTN_WIDTH, 3 * ATTN_WIDTH + SGU_WIDTH], axis=-1)
        q = partial_rotary(q.reshape(B, S, ATTN_HEADS, HEAD_DIM), positions).transpose(0, 2, 1, 3)
        k = partial_rotary(k.reshape(B, S, ATTN_HEADS, HEAD_DIM), positions).transpose(0, 2, 1, 3)
        v_a = v_a.reshape(B, S, ATTN_HEADS, HEAD_DIM).transpose(0, 2, 1, 3)
        attn = dilated_mixture_attention(q, k, v_a)
        attn = attn.transpose(0, 2, 1, 3).reshape(B, S, ATTN_WIDTH)
        sgu = spatial_gating(u, v_s, sgu_ln_gain[l], sgu_ln_bias[l],
                             sgu_w_spatial[l], sgu_b_spatial[l])
        mixed = jnp.concatenate([rms_norm(attn, attn_out_norm[l]),
                                 rms_norm(sgu, sgu_out_norm[l])], axis=-1)
        y = mixed @ w_out[l]
        x = x + rms_norm(y, post_mix_norm[l])
        h = rms_norm(x, pre_ffn_norm[l])
        f = (jax.nn.silu(h @ w_gate[l]) * (h @ w_up[l])) @ w_down[l]
        x = x + rms_norm(f, post_ffn_norm[l])
    return x
```

```cpp
#include <hip/hip_runtime.h>
#include <cstdio>
#include <cstdint>
#include <cmath>

constexpr int D = 1024, BATCH = 8, SEQ = 2048, M = BATCH * SEQ;
constexpr int AW = 512, SW = 512, NH = 8, HD = 64, FF = 2816, NP = 2560;
constexpr float RMS_EPS = 1e-6f, LN_EPS = 1e-5f;

__device__ __forceinline__ float wave_sum(float v) {
#pragma unroll
    for (int o = 1; o < 64; o <<= 1) v += __shfl_xor(v, o);
    return v;
}

__global__ void k_rms(const float* in, int ldi, const float* gain, const float* base, int ldb, float* out, int ldo, int width, int rows) {
    const int row = blockIdx.x * 4 + (threadIdx.x >> 6), lane = threadIdx.x & 63;
    if (row >= rows) return;
    const float* r = in + (size_t)row * ldi;
    float s = 0.f;
    for (int c = lane; c < width; c += 64) { float v = r[c]; s += v * v; }
    s = wave_sum(s);
    const float rstd = 1.0f / sqrtf(s / (float)width + RMS_EPS);
    for (int c = lane; c < width; c += 64) {
        float v = r[c] * rstd * gain[c];
        if (base) v += base[(size_t)row * ldb + c];
        out[(size_t)row * ldo + c] = v;
    }
}

__global__ void __launch_bounds__(256) k_sgemm(const float* __restrict__ A, int lda, const float* __restrict__ B, int ldb, float* __restrict__ C, int ldc, int K) {
    __shared__ float As[16][68], Bs[16][68];
    const int tid = threadIdx.x, tx = tid & 15, ty = tid >> 4;
    const int m0 = blockIdx.y * 64, n0 = blockIdx.x * 64;
    float acc[4][4];
#pragma unroll
    for (int i = 0; i < 4; ++i)
#pragma unroll
        for (int j = 0; j < 4; ++j) acc[i][j] = 0.f;
    for (int k0 = 0; k0 < K; k0 += 16) {
        {
            const int m = tid >> 2, kk = (tid & 3) * 4;
            const float4 a = *(const float4*)(A + (size_t)(m0 + m) * lda + k0 + kk);
            As[kk + 0][m] = a.x; As[kk + 1][m] = a.y; As[kk + 2][m] = a.z; As[kk + 3][m] = a.w;
            const int kb = tid >> 4, nn = (tid & 15) * 4;
            const float4 b = *(const float4*)(B + (size_t)(k0 + kb) * ldb + n0 + nn);
            Bs[kb][nn + 0] = b.x; Bs[kb][nn + 1] = b.y; Bs[kb][nn + 2] = b.z; Bs[kb][nn + 3] = b.w;
        }
        __syncthreads();
#pragma unroll
        for (int k = 0; k < 16; ++k) {
            float a[4], b[4];
#pragma unroll
            for (int i = 0; i < 4; ++i) a[i] = As[k][ty * 4 + i];
#pragma unroll
            for (int j = 0; j < 4; ++j) b[j] = Bs[k][tx * 4 + j];
#pragma unroll
            for (int i = 0; i < 4; ++i)
#pragma unroll
                for (int j = 0; j < 4; ++j) acc[i][j] += a[i] * b[j];
        }
        __syncthreads();
    }
#pragma unroll
    for (int i = 0; i < 4; ++i) {
        float4 o = {acc[i][0], acc[i][1], acc[i][2], acc[i][3]};
        *(float4*)(C + (size_t)(m0 + ty * 4 + i) * ldc + n0 + tx * 4) = o;
    }
}

__global__ void k_rotary(float* proj, const int* pos) {
    const int idx = blockIdx.x * 256 + threadIdx.x;
    if (idx >= M * 128) return;
    const int i = idx & 7, h = (idx >> 3) & 7, qk = (idx >> 6) & 1, tok = idx >> 7;
    const float inv_freq = powf(500000.0f, -(float)(2 * i) / 16.0f);
    const float ang = (float)pos[tok] * inv_freq;
    float sn, cs; sincosf(ang, &sn, &cs);
    float* p = proj + (size_t)tok * NP + qk * 512 + h * 64;
    const float x1 = p[i], x2 = p[i + 8];
    p[i] = x1 * cs - x2 * sn; p[i + 8] = x2 * cs + x1 * sn;
}

__global__ void __launch_bounds__(64) k_attn(const float* __restrict__ proj, float* __restrict__ mixed) {
    const int idx = blockIdx.x * 64 + threadIdx.x;
    const int t = idx & 2047, h = (idx >> 11) & 7, b = idx >> 14;
    const float* base = proj + (size_t)b * SEQ * NP + h * 64;
    float4 q[16], o[16];
    const float4* qp = (const float4*)(base + (size_t)t * NP);
#pragma unroll
    for (int i = 0; i < 16; ++i) { q[i] = qp[i]; o[i] = make_float4(0.f, 0.f, 0.f, 0.f); }
    float mx = -INFINITY, l = 0.f;
    for (int p = 0; p < 3; ++p) {
        const int dil = (p == 0) ? 1 : (p == 1) ? 4 : 16;
        for (int j = 0; j <= 128; ++j) {
            const int kt = t - dil * j;
            if (kt < 0) break;
            const float4* kp = (const float4*)(base + (size_t)kt * NP + 512);
            const float4* vp = (const float4*)(base + (size_t)kt * NP + 1024);
            float s = 0.f;
#pragma unroll
            for (int i = 0; i < 16; ++i) { const float4 k4 = kp[i]; s += q[i].x * k4.x + q[i].y * k4.y + q[i].z * k4.z + q[i].w * k4.w; }
            s *= 0.125f;
            const float mn = fmaxf(mx, s);
            const float f = expf(mx - mn), pw = expf(s - mn);
            l = l * f + pw; mx = mn;
#pragma unroll
            for (int i = 0; i < 16; ++i) { const float4 v4 = vp[i];
                o[i].x = o[i].x * f + pw * v4.x; o[i].y = o[i].y * f + pw * v4.y; o[i].z = o[i].z * f + pw * v4.z; o[i].w = o[i].w * f + pw * v4.w; }
        }
    }
    const float il = 1.0f / l;
    float4* op = (float4*)(mixed + ((size_t)b * SEQ + t) * D + h * 64);
#pragma unroll
    for (int i = 0; i < 16; ++i) op[i] = make_float4(o[i].x * il, o[i].y * il, o[i].z * il, o[i].w * il);
}

__device__ __forceinline__ float gelu_exact(float v) { return 0.5f * v * (1.0f + erff(v * 0.70710678118654752f)); }

__global__ void k_sgu1(float* proj, const float* lng, const float* lnb) {
    const int row = blockIdx.x * 4 + (threadIdx.x >> 6), lane = threadIdx.x & 63;
    float* u = proj + (size_t)row * NP + 1536; float* v = u + 512;
    float gv[8]; float s = 0.f;
#pragma unroll
    for (int j = 0; j < 8; ++j) { const int c = lane + 64 * j; u[c] = gelu_exact(u[c]); gv[j] = gelu_exact(v[c]); s += gv[j]; }
    const float mean = wave_sum(s) / 512.0f; float s2 = 0.f;
#pragma unroll
    for (int j = 0; j < 8; ++j) { gv[j] -= mean; s2 += gv[j] * gv[j]; }
    const float rstd = 1.0f / sqrtf(wave_sum(s2) / 512.0f + LN_EPS);
#pragma unroll
    for (int j = 0; j < 8; ++j) { const int c = lane + 64 * j; v[c] = gv[j] * rstd * lng[c] + lnb[c]; }
}
__global__ void k_sgu2(const float* __restrict__ proj, const float* __restrict__ wsp, const float* __restrict__ bsp, float* __restrict__ mixed) {
    const int idx = blockIdx.x * 256 + threadIdx.x;
    const int ch = idx & 511, tok = idx >> 9;
    const int i = tok & 127, tok0 = tok - i, g = ch >> 6;
    const float* w = wsp + ((size_t)g * 128 + i) * 128;
    float acc = 0.f;
    for (int j = 0; j <= i; ++j) acc += w[j] * proj[(size_t)(tok0 + j) * NP + 2048 + ch];
    acc += bsp[g * 128 + i];
    mixed[(size_t)tok * D + 512 + ch] = proj[(size_t)tok * NP + 1536 + ch] * acc;
}
__global__ void k_swiglu(float* g, const float* u, size_t n) {
    const size_t i = (size_t)blockIdx.x * 256 + threadIdx.x;
    if (i < n) { const float a = g[i]; g[i] = a / (1.0f + expf(-a)) * u[i]; }
}

extern "C" void kernel_launch(void* const* d_in, const int* in_sizes, int n_in, void* d_out, int out_size, void* d_ws, size_t ws_size, hipStream_t stream) {
    const float* x = (const float*)d_in[0]; const int* pos = (const int*)d_in[1];
    const float* g_pre = (const float*)d_in[2]; const float* w_in = (const float*)d_in[3];
    const float* lng = (const float*)d_in[4]; const float* lnb = (const float*)d_in[5];
    const float* wsp = (const float*)d_in[6]; const float* bsp = (const float*)d_in[7];
    const float* g_attn = (const float*)d_in[8]; const float* g_sgu = (const float*)d_in[9];
    const float* w_out = (const float*)d_in[10]; const float* g_postmix = (const float*)d_in[11];
    const float* g_preffn = (const float*)d_in[12]; const float* w_gate = (const float*)d_in[13];
    const float* w_up = (const float*)d_in[14]; const float* w_down = (const float*)d_in[15];
    const float* g_postffn = (const float*)d_in[16];
    float* out = (float*)d_out; char* ws = (char*)d_ws;
    const size_t MiB = 1u << 20;
    float* proj = (float*)(ws);
    float* mixed = (float*)(ws + 160 * MiB);
    float* y = (float*)(ws);
    float* x1 = (float*)(ws + 64 * MiB);
    float* gatec = (float*)(ws + 128 * MiB);
    float* upc = (float*)(ws + 172 * MiB);
    float* fc = (float*)(ws + 216 * MiB);
    float* h = out;

    k_rms<<<M / 4, 256, 0, stream>>>(x, D, g_pre, nullptr, 0, h, D, D, M);
    k_sgemm<<<dim3(NP / 64, M / 64), 256, 0, stream>>>(h, D, w_in, NP, proj, NP, D);
    k_rotary<<<M * 128 / 256, 256, 0, stream>>>(proj, pos);
    k_attn<<<M * NH / 64, 64, 0, stream>>>(proj, mixed);
    k_sgu1<<<M / 4, 256, 0, stream>>>(proj, lng, lnb);
    k_sgu2<<<M * 512 / 256, 256, 0, stream>>>(proj, wsp, bsp, mixed);
    k_rms<<<M / 4, 256, 0, stream>>>(mixed, D, g_attn, nullptr, 0, mixed, D, 512, M);
    k_rms<<<M / 4, 256, 0, stream>>>(mixed + 512, D, g_sgu, nullptr, 0, mixed + 512, D, 512, M);
    k_sgemm<<<dim3(D / 64, M / 64), 256, 0, stream>>>(mixed, D, w_out, D, y, D, D);
    k_rms<<<M / 4, 256, 0, stream>>>(y, D, g_postmix, x, D, x1, D, D, M);
    k_rms<<<M / 4, 256, 0, stream>>>(x1, D, g_preffn, nullptr, 0, h, D, D, M);
    for (int c = 0; c < 4; ++c) {
        const size_t r0 = (size_t)c * 4096;
        k_sgemm<<<dim3(FF / 64, 4096 / 64), 256, 0, stream>>>(h + r0 * D, D, w_gate, FF, gatec, FF, D);
        k_sgemm<<<dim3(FF / 64, 4096 / 64), 256, 0, stream>>>(h + r0 * D, D, w_up, FF, upc, FF, D);
        k_swiglu<<<(4096 * FF) / 256, 256, 0, stream>>>(gatec, upc, (size_t)4096 * FF);
        k_sgemm<<<dim3(D / 64, 4096 / 64), 256, 0, stream>>>(gatec, FF, w_down, D, fc, D, FF);
        k_rms<<<4096 / 4, 256, 0, stream>>>(fc, D, g_postffn, x1 + r0 * D, D, out + r0 * D, D, D, 4096);
    }
}
```
